# Optimizing an MI355X kernel written in HIP

```python
import jax, jax.numpy as jnp
from jax import lax
import numpy as np

D_MODEL = 1024
BATCH = 4
SEQ = 4096
DEPTH = 1

HEAD_DIM = 64
N_ATTN_HEADS = D_MODEL // (2 * HEAD_DIM)
N_GMLP_GROUPS = D_MODEL // (2 * HEAD_DIM)
ATTN_WIDTH = N_ATTN_HEADS * HEAD_DIM
GMLP_WIDTH = N_GMLP_GROUPS * HEAD_DIM
MIX_WIDTH = ATTN_WIDTH + GMLP_WIDTH
IN_PROJ_WIDTH = 3 * ATTN_WIDTH + 2 * GMLP_WIDTH
MOBA_BLOCK = 256
MOBA_TOPK = 3
Q_CHUNK = 128
GMLP_CHUNK = 128
ROPE_THETA = 10000.0
FFN_HIDDEN = -(-(8 * D_MODEL) // (3 * 256)) * 256
DEEPNORM_ALPHA = (2 * DEPTH) ** 0.25
DEEPNORM_BETA = (8 * DEPTH) ** -0.25
LN_EPS = 1e-5
RMS_EPS = 1e-6
NEG_INF = -1e30

kernel_name = "hymba_moba_gmlp_deepnorm_block"


def layer_norm(x, g, b):
    xf = x.astype(jnp.float32)
    mu = jnp.mean(xf, axis=-1, keepdims=True)
    var = jnp.mean(jnp.square(xf - mu), axis=-1, keepdims=True)
    return ((xf - mu) * lax.rsqrt(var + LN_EPS) * g.astype(jnp.float32) + b.astype(jnp.float32)).astype(x.dtype)


def rms_norm(x, g):
    xf = x.astype(jnp.float32)
    ms = jnp.mean(jnp.square(xf), axis=-1, keepdims=True)
    return (xf * lax.rsqrt(ms + RMS_EPS) * g.astype(jnp.float32)).astype(x.dtype)


def rope(t, pos):
    inv_freq = ROPE_THETA ** (-jnp.arange(0, HEAD_DIM, 2, dtype=jnp.float32) / HEAD_DIM)
    ang = pos.astype(jnp.float32)[:, None] * inv_freq[None, :]
    ang = jnp.concatenate([ang, ang], axis=-1)
    cos = jnp.cos(ang).astype(t.dtype)
    sin = jnp.sin(ang).astype(t.dtype)
    t1, t2 = t[..., : HEAD_DIM // 2], t[..., HEAD_DIM // 2:]
    rot = jnp.concatenate([-t2, t1], axis=-1)
    return t * cos + rot * sin


def moba_attention(q, k, v):
    B, H, S, hd = q.shape
    nb = -(-S // MOBA_BLOCK)
    pad = nb * MOBA_BLOCK - S
    kb = jnp.pad(k, ((0, 0), (0, 0), (0, pad), (0, 0))).reshape(B, H, nb, MOBA_BLOCK, hd)
    vb = jnp.pad(v, ((0, 0), (0, 0), (0, pad), (0, 0))).reshape(B, H, nb, MOBA_BLOCK, hd)
    pos = jnp.arange(S, dtype=jnp.int32)
    own = pos // MOBA_BLOCK
    own_idx = jnp.broadcast_to(own[None, None, :, None], (B, H, S, 1)).astype(jnp.int32)
    n_sel = min(MOBA_TOPK, nb - 1)
    if n_sel > 0:
        k_mean = jnp.mean(kb.astype(jnp.float32), axis=3)
        gate = jnp.einsum('bhsd,bhnd->bhsn', q.astype(jnp.float32), k_mean)
        past = jnp.arange(nb, dtype=jnp.int32)[None, :] < own[:, None]
        gate = jnp.where(past[None, None], gate, NEG_INF)
        _, sel = lax.top_k(gate, n_sel)
        idx = jnp.concatenate([sel.astype(jnp.int32), own_idx], axis=-1)
    else:
        idx = own_idx
    nsb = idx.shape[-1]
    n_chunks = S // Q_CHUNK
    q_c = q.reshape(B, H, n_chunks, Q_CHUNK, hd).transpose(2, 0, 1, 3, 4)
    idx_c = idx.reshape(B, H, n_chunks, Q_CHUNK, nsb).transpose(2, 0, 1, 3, 4)
    pos_c = pos.reshape(n_chunks, Q_CHUNK)
    b_ix = jnp.arange(B)[:, None, None, None]
    h_ix = jnp.arange(H)[None, :, None, None]
    key_off = jnp.arange(MOBA_BLOCK, dtype=jnp.int32)
    slot_own = jnp.arange(nsb) == nsb - 1
    scale = HEAD_DIM ** -0.5

    def attend(args):
        qc, ic, pc = args
        kg = kb[b_ix, h_ix, ic]
        vg = vb[b_ix, h_ix, ic]
        s = jnp.einsum('bhqd,bhqnkd->bhqnk', qc, kg).astype(jnp.float32) * scale
        own_c = pc // MOBA_BLOCK
        valid_blk = slot_own | (ic < own_c[:, None])
        key_pos = ic[..., None] * MOBA_BLOCK + key_off
        mask = valid_blk[..., None] & (key_pos <= pc[:, None, None])
        s = jnp.where(mask, s, NEG_INF)
        p = jax.nn.softmax(s.reshape(B, H, Q_CHUNK, nsb * MOBA_BLOCK), axis=-1)
        p = p.reshape(B, H, Q_CHUNK, nsb, MOBA_BLOCK).astype(vg.dtype)
        return jnp.einsum('bhqnk,bhqnkd->bhqd', p, vg)

    out = lax.map(attend, (q_c, idx_c, pos_c))
    return out.transpose(1, 2, 0, 3, 4).reshape(B, H, S, hd)


def spatial_gating(u, z, ln_g, ln_b, w_s, b_s):
    B, S, G, dg = z.shape
    z = layer_norm(z, ln_g, ln_b)
    nc = S // GMLP_CHUNK
    zc = z.reshape(B, nc, GMLP_CHUNK, G, dg)
    tril = jnp.tril(jnp.ones((GMLP_CHUNK, GMLP_CHUNK), dtype=bool))
    w = jnp.where(tril[None], w_s, jnp.zeros_like(w_s))
    mixed = jnp.einsum('gij,bcjgd->bcigd', w, zc) + b_s.T[None, None, :, :, None]
    return u * mixed.reshape(B, S, G, dg)


def hybrid_mixer(x, w_in, attn_out_g, gmlp_out_g, gmlp_ln_g, gmlp_ln_b, w_spatial, b_spatial, w_out):
    B, S, _ = x.shape
    h = x @ w_in
    A, G = ATTN_WIDTH, GMLP_WIDTH
    q, k, v, u, z = jnp.split(h, [A, 2 * A, 3 * A, 3 * A + G], axis=-1)

    def heads(t):
        return t.reshape(B, S, N_ATTN_HEADS, HEAD_DIM).transpose(0, 2, 1, 3)

    pos = jnp.arange(S, dtype=jnp.int32)
    qh = rope(heads(q), pos)
    kh = rope(heads(k), pos)
    attn = moba_attention(qh, kh, heads(v)).transpose(0, 2, 1, 3).reshape(B, S, A)

    u = jax.nn.gelu(u, approximate=False).reshape(B, S, N_GMLP_GROUPS, HEAD_DIM)
    z = jax.nn.gelu(z, approximate=False).reshape(B, S, N_GMLP_GROUPS, HEAD_DIM)
    sg = spatial_gating(u, z, gmlp_ln_g, gmlp_ln_b, w_spatial, b_spatial).reshape(B, S, G)

    merged = jnp.concatenate([rms_norm(attn, attn_out_g), rms_norm(sg, gmlp_out_g)], axis=-1)
    return merged @ w_out


def swiglu_ffn(x, w_gate, w_up, w_down):
    return (jax.nn.silu(x @ w_gate) * (x @ w_up)) @ w_down


def setup_inputs(seed: int = 0) -> dict:
    key = jax.random.key(seed)
    ks = jax.random.split(key, 16)
    nrm = jax.random.normal
    f32 = jnp.float32
    x = nrm(ks[0], (BATCH, SEQ, D_MODEL), f32)
    w_in = nrm(ks[1], (DEPTH, D_MODEL, IN_PROJ_WIDTH), f32) * D_MODEL ** -0.5
    attn_out_g = 1.0 + 0.1 * nrm(ks[2], (DEPTH, ATTN_WIDTH), f32)
    gmlp_out_g = 1.0 + 0.1 * nrm(ks[3], (DEPTH, GMLP_WIDTH), f32)
    gmlp_ln_g = 1.0 + 0.1 * nrm(ks[4], (DEPTH, N_GMLP_GROUPS, HEAD_DIM), f32)
    gmlp_ln_b = 0.02 * nrm(ks[5], (DEPTH, N_GMLP_GROUPS, HEAD_DIM), f32)
    w_spatial = nrm(ks[6], (DEPTH, N_GMLP_GROUPS, GMLP_CHUNK, GMLP_CHUNK), f32) * GMLP_CHUNK ** -0.5
    b_spatial = 1.0 + 0.1 * nrm(ks[7], (DEPTH, N_GMLP_GROUPS, GMLP_CHUNK), f32)
    w_out = nrm(ks[8], (DEPTH, MIX_WIDTH, D_MODEL), f32) * (MIX_WIDTH ** -0.5 * DEEPNORM_BETA)
    ln1_g = 1.0 + 0.1 * nrm(ks[9], (DEPTH, D_MODEL), f32)
    ln1_b = 0.02 * nrm(ks[10], (DEPTH, D_MODEL), f32)
    w_gate = nrm(ks[11], (DEPTH, D_MODEL, FFN_HIDDEN), f32) * D_MODEL ** -0.5
    w_up = nrm(ks[12], (DEPTH, D_MODEL, FFN_HIDDEN), f32) * D_MODEL ** -0.5
    w_down = nrm(ks[13], (DEPTH, FFN_HIDDEN, D_MODEL), f32) * (FFN_HIDDEN ** -0.5 * DEEPNORM_BETA)
    ln2_g = 1.0 + 0.1 * nrm(ks[14], (DEPTH, D_MODEL), f32)
    ln2_b = 0.02 * nrm(ks[15], (DEPTH, D_MODEL), f32)
    return {"x": x, "w_in": w_in, "attn_out_g": attn_out_g, "gmlp_out_g": gmlp_out_g,
            "gmlp_ln_g": gmlp_ln_g, "gmlp_ln_b": gmlp_ln_b, "w_spatial": w_spatial,
            "b_spatial": b_spatial, "w_out": w_out, "ln1_g": ln1_g, "ln1_b": ln1_b,
            "w_gate": w_gate, "w_up": w_up, "w_down": w_down, "ln2_g": ln2_g, "ln2_b": ln2_b}


def reference(x, w_in, attn_out_g, gmlp_out_g, gmlp_ln_g, gmlp_ln_b, w_spatial, b_spatial,
              w_out, ln1_g, ln1_b, w_gate, w_up, w_down, ln2_g, ln2_b):
    for l in range(DEPTH):
        mix = hybrid_mixer(x, w_in[l], attn_out_g[l], gmlp_out_g[l], gmlp_ln_g[l], gmlp_ln_b[l],
                           w_spatial[l], b_spatial[l], w_out[l])
        x = layer_norm(DEEPNORM_ALPHA * x + mix, ln1_g[l], ln1_b[l])
        ffn = swiglu_ffn(x, w_gate[l], w_up[l], w_down[l])
        x = layer_norm(DEEPNORM_ALPHA * x + ffn, ln2_g[l], ln2_b[l])
    return x
```

```cpp
#include <hip/hip_runtime.h>
#include <cstdio>
#include <cstdint>
#include <cmath>
namespace nv {
constexpr int S = 4096, DM = 1024, NH = 8, HD = 64, IPW = 2560, FF = 2816;
constexpr float ALPHA = 1.189207115002721f;
constexpr size_t MB = 1u << 20;
constexpr size_t O_H = 0, O_Q = 40 * MB, O_K = 48 * MB, O_V = 56 * MB, O_UG = 64 * MB, O_ZL = 72 * MB, O_SG = 80 * MB, O_AT = 88 * MB, O_KM = 96 * MB;
constexpr size_t O_MG = 0, O_MIX = 16 * MB, O_X1 = 32 * MB, O_G = 48 * MB, O_U2 = 71 * MB, O_F = 0;
constexpr size_t NAIVE_BYTES = 97 * MB;

__global__ __launch_bounds__(256) void sgemm(const float* __restrict__ A, int lda, const float* __restrict__ B, int ldb, float* __restrict__ C, int ldc, int K) {
    __shared__ float As[16][132];
    __shared__ float Bs[16][132];
    const int tid = threadIdx.x, tx = tid & 15, ty = tid >> 4;
    const int bm = blockIdx.y * 128, bn = blockIdx.x * 128;
    float acc[8][8];
#pragma unroll
    for (int i = 0; i < 8; ++i)
#pragma unroll
        for (int j = 0; j < 8; ++j) acc[i][j] = 0.f;
    for (int k0 = 0; k0 < K; k0 += 16) {
#pragma unroll
        for (int i = 0; i < 2; ++i) {
            const int idx = tid + i * 256; const int r = idx >> 2, c = (idx & 3) * 4;
            const float4 v = *(const float4*)&A[(size_t)(bm + r) * lda + k0 + c];
            As[c + 0][r] = v.x; As[c + 1][r] = v.y; As[c + 2][r] = v.z; As[c + 3][r] = v.w;
            const int rb = idx >> 5, cb = (idx & 31) * 4;
            *(float4*)&Bs[rb][cb] = *(const float4*)&B[(size_t)(k0 + rb) * ldb + bn + cb];
        }
        __syncthreads();
#pragma unroll
        for (int kk = 0; kk < 16; ++kk) {
            float a[8], b[8];
            const float4 a0 = *(const float4*)&As[kk][ty * 8], a1 = *(const float4*)&As[kk][ty * 8 + 4];
            const float4 b0 = *(const float4*)&Bs[kk][tx * 8], b1 = *(const float4*)&Bs[kk][tx * 8 + 4];
            a[0] = a0.x; a[1] = a0.y; a[2] = a0.z; a[3] = a0.w; a[4] = a1.x; a[5] = a1.y; a[6] = a1.z; a[7] = a1.w;
            b[0] = b0.x; b[1] = b0.y; b[2] = b0.z; b[3] = b0.w; b[4] = b1.x; b[5] = b1.y; b[6] = b1.z; b[7] = b1.w;
#pragma unroll
            for (int i = 0; i < 8; ++i)
#pragma unroll
                for (int j = 0; j < 8; ++j) acc[i][j] = fmaf(a[i], b[j], acc[i][j]);
        }
        __syncthreads();
    }
#pragma unroll
    for (int i = 0; i < 8; ++i) {
        float* cp = &C[(size_t)(bm + ty * 8 + i) * ldc + bn + tx * 8];
        *(float4*)cp = make_float4(acc[i][0], acc[i][1], acc[i][2], acc[i][3]);
        *(float4*)(cp + 4) = make_float4(acc[i][4], acc[i][5], acc[i][6], acc[i][7]);
    }
}

__global__ void rope_split(const float* __restrict__ H, float* Qr, float* Kr, float* Vr) {
    const int gid = blockIdx.x * blockDim.x + threadIdx.x;
    const int d = gid & 31, hh = (gid >> 5) & 7, s = gid >> 8;
    const float inv_freq = (float)pow(10000.0, -(double)(2 * d) / 64.0);
    const float ang = (float)s * inv_freq;
    const float c = (float)cos((double)ang), sn = (float)sin((double)ang);
    const float* h = H + (size_t)s * IPW;
    const size_t o = ((size_t)hh * S + s) * 64 + d;
    { const float t1 = h[64 * hh + d], t2 = h[64 * hh + d + 32]; Qr[o] = t1 * c - t2 * sn; Qr[o + 32] = t2 * c + t1 * sn; }
    { const float t1 = h[512 + 64 * hh + d], t2 = h[512 + 64 * hh + d + 32]; Kr[o] = t1 * c - t2 * sn; Kr[o + 32] = t2 * c + t1 * sn; }
    Vr[o] = h[1024 + 64 * hh + d]; Vr[o + 32] = h[1024 + 64 * hh + d + 32];
}
__global__ void kmean_k(const float* __restrict__ Kr, float* km) {
    const int gid = blockIdx.x * blockDim.x + threadIdx.x; const int d = gid & 63, n = (gid >> 6) & 15, hh = gid >> 10;
    float s = 0.f; for (int j = 0; j < 256; ++j) s += Kr[((size_t)hh * S + n * 256 + j) * 64 + d];
    km[gid] = s * (1.0f / 256.0f);
}
__device__ __forceinline__ float wsum(float v) {
#pragma unroll
    for (int o = 32; o >= 1; o >>= 1) v += __shfl_xor(v, o);
    return v;
}
__device__ __forceinline__ float wmax(float v) {
#pragma unroll
    for (int o = 32; o >= 1; o >>= 1) v = fmaxf(v, __shfl_xor(v, o));
    return v;
}
__device__ __forceinline__ float gelu_exact(float x) { return 0.5f * x * (1.0f + erff(x * 0.70710678118654752f)); }
__global__ __launch_bounds__(256) void gmlp_prep(const float* __restrict__ H, const float* __restrict__ lng, const float* __restrict__ lnb, float* Ug, float* Zl) {
    const int w = (blockIdx.x * 256 + threadIdx.x) >> 6, lane = threadIdx.x & 63; const int g = w & 7, s = w >> 3;
    const float u = H[(size_t)s * IPW + 1536 + 64 * g + lane], z = gelu_exact(H[(size_t)s * IPW + 2048 + 64 * g + lane]);
    Ug[(size_t)s * 512 + 64 * g + lane] = gelu_exact(u);
    const float mu = wsum(z) * (1.f / 64.f); const float dz = z - mu; const float var = wsum(dz * dz) * (1.f / 64.f);
    Zl[(size_t)s * 512 + 64 * g + lane] = dz * rsqrtf(var + 1e-5f) * lng[64 * g + lane] + lnb[64 * g + lane];
}
__global__ void spatial(const float* __restrict__ Ug, const float* __restrict__ Zl, const float* __restrict__ ws, const float* __restrict__ bs, float* SG) {
    const int gid = blockIdx.x * blockDim.x + threadIdx.x; const int c = gid & 511, s = gid >> 9; const int g = c >> 6, i = s & 127, s0 = s & ~127;
    const float* wr = ws + ((size_t)g * 128 + i) * 128;
    float m = 0.f; for (int j = 0; j <= i; ++j) m += wr[j] * Zl[(size_t)(s0 + j) * 512 + c];
    m += bs[g * 128 + i];
    SG[gid] = Ug[gid] * m;
}
__global__ __launch_bounds__(256) void attn_naive(const float* __restrict__ Qr, const float* __restrict__ Kr, const float* __restrict__ Vr, const float* __restrict__ km, float* At) {
    __shared__ float sh[4][64 + 1024];
    const int wave = threadIdx.x >> 6, lane = threadIdx.x & 63; const int gid = blockIdx.x * 4 + wave; const int hh = gid >> 12, s = gid & 4095, own = s >> 8;
    float* q = sh[wave]; float* p = q + 64;
    q[lane] = Qr[((size_t)hh * S + s) * 64 + lane];
    __syncthreads();
    float g = -1e30f;
    if (lane < 16 && lane < own) { g = 0.f; for (int d = 0; d < 64; ++d) g += q[d] * km[(hh * 16 + lane) * 64 + d]; }
    int rank = 0;
    for (int m = 0; m < 16; ++m) { const float gm = __shfl(g, m); if (m != lane && (gm > g || (gm == g && m < lane))) ++rank; }
    const bool selb = lane < 16 && ((lane < own && rank < 3) || lane == own);
    const unsigned long long mask = __ballot(selb);
    float mx = -1e30f; int cslot = 0;
    for (int n = 0; n < 16; ++n) if ((mask >> n) & 1ull) {
        for (int i = 0; i < 4; ++i) { const int key = n * 256 + i * 64 + lane; float sc = -1e30f;
            if (key <= s) { const float* kr = Kr + ((size_t)hh * S + key) * 64; float a = 0.f; for (int d = 0; d < 64; ++d) a += q[d] * kr[d]; sc = a * 0.125f; }
            p[cslot * 256 + i * 64 + lane] = sc; mx = fmaxf(mx, sc); }
        ++cslot; }
    mx = wmax(mx);
    float sum = 0.f;
    for (int i = 0; i < cslot * 4; ++i) { const float e = __expf(p[i * 64 + lane] - mx) ; p[i * 64 + lane] = e; sum += e; }
    sum = wsum(sum);
    __syncthreads();
    float o = 0.f; cslot = 0;
    for (int n = 0; n < 16; ++n) if ((mask >> n) & 1ull) {
        for (int j = 0; j < 256; ++j) o += p[cslot * 256 + j] * Vr[((size_t)hh * S + n * 256 + j) * 64 + lane];
        ++cslot; }
    At[(size_t)s * 512 + hh * 64 + lane] = o / sum;
}
__global__ __launch_bounds__(256) void rms_merge(const float* __restrict__ At, const float* __restrict__ SG, const float* __restrict__ ga, const float* __restrict__ gg, float* Mg) {
    const int s = (blockIdx.x * 256 + threadIdx.x) >> 6, lane = threadIdx.x & 63;
    float a[8], b[8], sa = 0.f, sb = 0.f;
#pragma unroll
    for (int i = 0; i < 8; ++i) { a[i] = At[(size_t)s * 512 + i * 64 + lane]; b[i] = SG[(size_t)s * 512 + i * 64 + lane]; sa += a[i] * a[i]; sb += b[i] * b[i]; }
    const float ra = rsqrtf(wsum(sa) * (1.f / 512.f) + 1e-6f), rb = rsqrtf(wsum(sb) * (1.f / 512.f) + 1e-6f);
#pragma unroll
    for (int i = 0; i < 8; ++i) { Mg[(size_t)s * 1024 + i * 64 + lane] = a[i] * ra * ga[i * 64 + lane]; Mg[(size_t)s * 1024 + 512 + i * 64 + lane] = b[i] * rb * gg[i * 64 + lane]; }
}
__global__ __launch_bounds__(256) void resid_ln(const float* __restrict__ xin, const float* __restrict__ add, const float* __restrict__ g, const float* __restrict__ b, float* out, const float* escale) {
    const int s = (blockIdx.x * 256 + threadIdx.x) >> 6, lane = threadIdx.x & 63;
    float v[16]; float sm = 0.f;
#pragma unroll
    for (int i = 0; i < 16; ++i) { v[i] = ALPHA * xin[(size_t)s * 1024 + i * 64 + lane] + add[(size_t)s * 1024 + i * 64 + lane]; sm += v[i]; }
    const float mu = wsum(sm) * (1.f / 1024.f); float q = 0.f;
#pragma unroll
    for (int i = 0; i < 16; ++i) { v[i] -= mu; q += v[i] * v[i]; }
    const float rstd = rsqrtf(wsum(q) * (1.f / 1024.f) + 1e-5f);
    const float es = escale ? (1.0f + *escale) : 1.0f;
#pragma unroll
    for (int i = 0; i < 16; ++i) out[(size_t)s * 1024 + i * 64 + lane] = (v[i] * rstd * g[i * 64 + lane] + b[i * 64 + lane]) * es;
}
__global__ void silu_mul(float* G, const float* __restrict__ U, size_t n) {
    const size_t i = (size_t)blockIdx.x * blockDim.x + threadIdx.x; if (i < n) { const float g = G[i]; G[i] = g / (1.0f + __expf(-g)) * U[i]; }
}

struct In { const float *x, *w_in, *ga, *gg, *lng, *lnb, *ws, *bs, *w_out, *l1g, *l1b, *wg, *wu, *wd, *l2g, *l2b; };
typedef void (*hook_t)(int stage, int b, unsigned char* nb, hipStream_t st, void* user);
static void run(const In& I, float* out, unsigned char* nb, hipStream_t st, hook_t hook, void* user, const float* escale) {
    for (int b = 0; b < 4; ++b) {
        const float* xb = I.x + (size_t)b * S * DM; float* ob = out + (size_t)b * S * DM;
        float *H = (float*)(nb + O_H), *Qr = (float*)(nb + O_Q), *Kr = (float*)(nb + O_K), *Vr = (float*)(nb + O_V), *Ug = (float*)(nb + O_UG), *Zl = (float*)(nb + O_ZL), *SG = (float*)(nb + O_SG), *At = (float*)(nb + O_AT), *KM = (float*)(nb + O_KM);
        float *Mg = (float*)(nb + O_MG), *Mix = (float*)(nb + O_MIX), *X1 = (float*)(nb + O_X1), *G = (float*)(nb + O_G), *U2 = (float*)(nb + O_U2), *F = (float*)(nb + O_F);
        sgemm<<<dim3(IPW / 128, S / 128), 256, 0, st>>>(xb, DM, I.w_in, IPW, H, IPW, DM);
        rope_split<<<S * NH * 32 / 256, 256, 0, st>>>(H, Qr, Kr, Vr);
        kmean_k<<<8192 / 256, 256, 0, st>>>(Kr, KM);
        gmlp_prep<<<S * 8 / 4, 256, 0, st>>>(H, I.lng, I.lnb, Ug, Zl);
        if (hook) hook(1, b, nb, st, user);
        spatial<<<S * 512 / 256, 256, 0, st>>>(Ug, Zl, I.ws, I.bs, SG);
        attn_naive<<<NH * S / 4, 256, 0, st>>>(Qr, Kr, Vr, KM, At);
        if (hook) hook(2, b, nb, st, user);
        rms_merge<<<S / 4, 256, 0, st>>>(At, SG, I.ga, I.gg, Mg);
        sgemm<<<dim3(DM / 128, S / 128), 256, 0, st>>>(Mg, DM, I.w_out, DM, Mix, DM, DM);
        resid_ln<<<S / 4, 256, 0, st>>>(xb, Mix, I.l1g, I.l1b, X1, nullptr);
        if (hook) hook(3, b, nb, st, user);
        for (int c = 0; c < 2; ++c) {
            const float* x1c = X1 + (size_t)c * 2048 * DM;
            sgemm<<<dim3(FF / 128, 2048 / 128), 256, 0, st>>>(x1c, DM, I.wg, FF, G, FF, DM);
            sgemm<<<dim3(FF / 128, 2048 / 128), 256, 0, st>>>(x1c, DM, I.wu, FF, U2, FF, DM);
            silu_mul<<<(2048 * FF + 255) / 256, 256, 0, st>>>(G, U2, (size_t)2048 * FF);
            if (hook) hook(4, b * 2 + c, nb, st, user);
            sgemm<<<dim3(DM / 128, 2048 / 128), 256, 0, st>>>(G, FF, I.wd, DM, F + (size_t)c * 2048 * DM, DM, FF);
        }
        if (hook) hook(5, b, nb, st, user);
        resid_ln<<<S / 4, 256, 0, st>>>(X1, F, I.l2g, I.l2b, ob, escale);
    }
}
}
extern "C" void kernel_launch(void* const* d_in, const int* in_sizes, int n_in, void* d_out, int out_size, void* d_ws, size_t ws_size, hipStream_t stream) {
    nv::In I{(const float*)d_in[0], (const float*)d_in[1], (const float*)d_in[2], (const float*)d_in[3], (const float*)d_in[4], (const float*)d_in[5], (const float*)d_in[6], (const float*)d_in[7],
             (const float*)d_in[8], (const float*)d_in[9], (const float*)d_in[10], (const float*)d_in[11], (const float*)d_in[12], (const float*)d_in[13], (const float*)d_in[14], (const float*)d_in[15]};
    nv::run(I, (float*)d_out, (unsigned char*)d_ws, stream, nullptr, nullptr, nullptr);
}
```
